# Optimizing an MI355X kernel written in HIP

```python
import jax, jax.numpy as jnp
from jax import lax
import numpy as np


D_MODEL = 1024
BATCH = 8
SEQ = 4096
DEPTH = 4

ATT_HEAD_DIM = 64
D_ATT = D_MODEL // 2
N_ATT_HEADS = D_ATT // ATT_HEAD_DIM
D_CONV = D_MODEL // 2
N_CONV_GROUPS = 8
CONV_WIDTH = 31
Q_BLOCK = 128
LN_EPS = 1e-5
GATE_INIT_STD = 0.02
DEEPNORM_ALPHA = (2 * DEPTH) ** 0.25
DEEPNORM_BETA = (8 * DEPTH) ** -0.25
IN_WIDTHS = (D_ATT, D_ATT, D_ATT, D_ATT, D_CONV, D_CONV, D_CONV, D_MODEL, D_MODEL)
D_IN = sum(IN_WIDTHS)

kernel_name = 'stickbreak_conformer_gated_hybrid'


def _split_points():
    pts, acc = [], 0
    for w in IN_WIDTHS[:-1]:
        acc += w
        pts.append(acc)
    return pts


def layer_norm(x, g, b):
    xf = x.astype(jnp.float32)
    mu = jnp.mean(xf, axis=-1, keepdims=True)
    var = jnp.mean(jnp.square(xf - mu), axis=-1, keepdims=True)
    return ((xf - mu) * lax.rsqrt(var + LN_EPS) * g + b).astype(x.dtype)


def stick_breaking_attention(q, k, v):
    S = q.shape[1]
    scale = ATT_HEAD_DIM ** -0.5
    outs = []
    for blk in range(S // Q_BLOCK):
        q0 = blk * Q_BLOCK
        q1 = q0 + Q_BLOCK
        qb = q[:, q0:q1]
        kb = k[:, :q1]
        vb = v[:, :q1]
        z = jnp.einsum('bthd,bshd->bhts', qb, kb).astype(jnp.float32) * scale
        t_pos = q0 + jnp.arange(Q_BLOCK)[:, None]
        s_pos = jnp.arange(q1)[None, :]
        causal = s_pos < t_pos
        log_fail = jnp.where(causal, jax.nn.log_sigmoid(-z), 0.0)
        later = lax.cumsum(log_fail, axis=3, reverse=True) - log_fail
        w = jnp.where(causal, jnp.exp(jax.nn.log_sigmoid(z) + later), 0.0)
        outs.append(jnp.einsum('bhts,bshd->bthd', w.astype(vb.dtype), vb))
    return jnp.concatenate(outs, axis=1)


def causal_depthwise_conv(u, w, b):
    C = u.shape[-1]
    up = jnp.pad(u, ((0, 0), (CONV_WIDTH - 1, 0), (0, 0)))
    out = lax.conv_general_dilated(up, w[:, None, :].astype(u.dtype), window_strides=(1,), padding='VALID',
                                   dimension_numbers=('NWC', 'WIO', 'NWC'), feature_group_count=C)
    return out + b


def hybrid_layer(x, w_in, b_in, conv_w, conv_b, conv_ln_g, conv_ln_b,
                 w_att_proj, w_conv_proj, b_conv_proj, w_out, ln_g, ln_b):
    B, S, _ = x.shape
    u = jnp.einsum('bsd,de->bse', x, w_in) + b_in
    q, k, v, z_att, glu_a, glu_b, z_conv, g_att, g_conv = jnp.split(u, _split_points(), axis=-1)

    heads = lambda t: t.reshape(B, S, N_ATT_HEADS, ATT_HEAD_DIM)
    att = stick_breaking_attention(heads(q), heads(k), heads(v)).reshape(B, S, D_ATT)
    att_branch = jnp.einsum('bsc,cd->bsd', att * jax.nn.silu(z_att), w_att_proj)

    c = glu_a * jax.nn.sigmoid(glu_b)
    c = causal_depthwise_conv(c, conv_w, conv_b)
    c = jax.nn.silu(layer_norm(c, conv_ln_g, conv_ln_b))
    conv_branch = jnp.einsum('bsc,cd->bsd', c * jax.nn.silu(z_conv), w_conv_proj) + b_conv_proj

    merged = jax.nn.sigmoid(g_att) * att_branch + jax.nn.sigmoid(g_conv) * conv_branch
    y = jnp.einsum('bsd,de->bse', merged, w_out)
    return layer_norm(DEEPNORM_ALPHA * x + y, ln_g, ln_b)


def setup_inputs(seed: int = 0) -> dict:
    key = jax.random.key(seed)
    ks = jax.random.split(key, 13)
    L, D = DEPTH, D_MODEL
    nrm = lambda k, shape, s: jax.random.normal(k, shape, jnp.float32) * s
    x = nrm(ks[0], (BATCH, SEQ, D), 1.0)
    col_scale = jnp.ones((D_IN,), jnp.float32).at[2 * D_ATT:3 * D_ATT].set(DEEPNORM_BETA)
    w_in = nrm(ks[1], (L, D, D_IN), D ** -0.5) * col_scale
    b_in = nrm(ks[2], (L, D_IN), GATE_INIT_STD)
    conv_w = nrm(ks[3], (L, CONV_WIDTH, D_CONV), CONV_WIDTH ** -0.5)
    conv_b = nrm(ks[4], (L, D_CONV), GATE_INIT_STD)
    conv_ln_g = 1.0 + nrm(ks[5], (L, D_CONV), GATE_INIT_STD)
    conv_ln_b = nrm(ks[6], (L, D_CONV), GATE_INIT_STD)
    w_att_proj = nrm(ks[7], (L, D_ATT, D), D_ATT ** -0.5 * DEEPNORM_BETA)
    w_conv_proj = nrm(ks[8], (L, D_CONV, D), D_CONV ** -0.5 * DEEPNORM_BETA)
    b_conv_proj = nrm(ks[9], (L, D), GATE_INIT_STD)
    w_out = nrm(ks[10], (L, D, D), D ** -0.5 * DEEPNORM_BETA)
    ln_g = 1.0 + nrm(ks[11], (L, D), GATE_INIT_STD)
    ln_b = nrm(ks[12], (L, D), GATE_INIT_STD)
    return {'x': x, 'w_in': w_in, 'b_in': b_in, 'conv_w': conv_w, 'conv_b': conv_b,
            'conv_ln_g': conv_ln_g, 'conv_ln_b': conv_ln_b, 'w_att_proj': w_att_proj,
            'w_conv_proj': w_conv_proj, 'b_conv_proj': b_conv_proj, 'w_out': w_out,
            'ln_g': ln_g, 'ln_b': ln_b}


def reference(x, w_in, b_in, conv_w, conv_b, conv_ln_g, conv_ln_b,
              w_att_proj, w_conv_proj, b_conv_proj, w_out, ln_g, ln_b):
    for l in range(DEPTH):
        x = hybrid_layer(x, w_in[l], b_in[l], conv_w[l], conv_b[l], conv_ln_g[l], conv_ln_b[l],
                         w_att_proj[l], w_conv_proj[l], b_conv_proj[l], w_out[l], ln_g[l], ln_b[l])
    return x
```

```cpp
#include <hip/hip_runtime.h>
#include <hip/hip_cooperative_groups.h>
#include <cstdio>
#include <cstdint>
namespace cg = cooperative_groups;
namespace pg8 {
#define PG8_LAS __attribute__((address_space(3)))
typedef unsigned short bf16_t;
typedef short bf16x8 __attribute__((ext_vector_type(8)));
typedef float f32x4 __attribute__((ext_vector_type(4)));
typedef unsigned u32x4 __attribute__((ext_vector_type(4)));
constexpr int BM = 256, BK = 64, HALF = 128, HTB = HALF * BK * 2  , STAGE_BYTES = 8 * HTB, NXCD = 8, WGM = 8;

__host__ __device__ __forceinline__ int lds_byte(int r, int c) { const int st = (r >> 4) * 2 + (c >> 5), rr = r & 15, cc = c & 31, ob = rr * 64 + cc * 2; return st * 1024 + (ob ^ (((ob >> 9) & 1) << 5)); }
__host__ __device__ __forceinline__ void stage_rc(int b, int& R, int& C) { const int st = b / 1024, sb = b % 1024, swz = sb ^ (((sb >> 9) & 1) << 5); R = (st >> 1) * 16 + swz / 64; C = (st & 1) * 32 + (swz % 64) / 2; }
__host__ __device__ __forceinline__ int perm32(int rho) { const int n = rho >> 4, i = rho & 15; return 8 * (i >> 2) + 4 * n + (i & 3); }

struct Unit { int pm, pn; };
struct Gemm { const bf16_t* A; const bf16_t* Bt; int M, N, K, lda, ldb; };

struct StaticOrder {
    int nM, nN, nwg, G, c;
    __host__ __device__ void init(int M, int N, int G_, int c_) { nM = M / BM; nN = N / BM; nwg = nM * nN; G = G_; c = c_; }
    __host__ __device__ bool next(int i, Unit& u) const {
        const long L = (long)i * G + c; if (L >= nwg) return false;
        int wgid = (int)L; { const int q = nwg / NXCD, r = nwg % NXCD, xcd = wgid % NXCD, off = wgid / NXCD; wgid = (xcd < r ? xcd * (q + 1) : r * (q + 1) + (xcd - r) * q) + off; }
        const int nig = WGM * nN, gid = wgid / nig, fm = gid * WGM, gsz = (nM - fm) < WGM ? (nM - fm) : WGM;
        u.pm = fm + ((wgid % nig) % gsz); u.pn = (wgid % nig) / gsz; return true;
    }
    __device__ __forceinline__ void a_ready(const Unit&) const {}
    __device__ __forceinline__ void done(const Unit&) const {}
};
__device__ __forceinline__ unsigned cvt_pk_bf16(float lo, float hi) { unsigned r; asm volatile("v_cvt_pk_bf16_f32 %0, %1, %2" : "=v"(r) : "v"(lo), "v"(hi)); return r; }
template <class Epi, class Sched, bool ALIGN_EPI = false, bool SP2 = false>
__device__ __forceinline__ void gemm_phase(PG8_LAS unsigned char* lds, const Gemm g, const Sched& S, const Epi& E) {
    int tid_l = threadIdx.x; asm volatile("" : "+v"(tid_l));
    const int tid = tid_l, wid = __builtin_amdgcn_readfirstlane(tid >> 6), lane = tid & 63, wr = wid >> 2, wc = wid & 3, fr = lane & 15, fq = lane >> 4;
    const int K = g.K, nt = K / BK;
    unsigned voffA[2], voffB[2];
#pragma unroll
    for (int i = 0; i < 2; ++i) { int R, C; stage_rc(tid * 16 + i * 8192, R, C); const int Rb = Epi::PERM ? ((R & ~31) + perm32(R & 31)) : R;
        voffA[i] = (unsigned)(R * g.lda + C) * 2u; voffB[i] = (unsigned)(Rb * g.ldb + C) * 2u; }
    const size_t kstep = (size_t)(BK * 2);
    const size_t hstepA = (size_t)HALF * g.lda * 2, hstepB = (size_t)HALF * g.ldb * 2;
    const size_t tstepA = 2 * hstepA, tstepB = 2 * hstepB;
    const unsigned ldsw = (unsigned)wid * 1024u;
    const int aoff = lds_byte(wr * 64 + fr, fq * 8), boff = lds_byte(wc * 32 + fr, fq * 8);
#define PG8_SA(b, h) (((b) * 2 + (h)) * HTB)
#define PG8_SB(b, h) ((4 + (b) * 2 + (h)) * HTB)
#define PG8_STAGE(bufoff, gbase, voff) do { _Pragma("unroll") for (int _i = 0; _i < 2; ++_i) \
        __builtin_amdgcn_global_load_lds((const unsigned*)((const char*)(gbase) + (voff)[_i]), (PG8_LAS unsigned*)(lds + (bufoff) + ldsw + _i * 8192), 16, 0, 0); } while (0)
#define PG8_LDA(dst, b, h) do { _Pragma("unroll") for (int m = 0; m < 4; ++m) _Pragma("unroll") for (int k = 0; k < 2; ++k) dst[m][k] = *(const PG8_LAS bf16x8*)(lds + PG8_SA(b, h) + aoff + m * 2048 + k * 1024); } while (0)
#define PG8_LDB(dst, b, h) do { _Pragma("unroll") for (int n = 0; n < 2; ++n) _Pragma("unroll") for (int k = 0; k < 2; ++k) dst[n][k] = *(const PG8_LAS bf16x8*)(lds + PG8_SB(b, h) + boff + n * 2048 + k * 1024); } while (0)
#define PG8_MMA(ai, bj, At, Bt) do { __builtin_amdgcn_s_setprio(1); _Pragma("unroll") for (int m = 0; m < 4; ++m) _Pragma("unroll") for (int n = 0; n < 2; ++n) _Pragma("unroll") for (int k = 0; k < 2; ++k) \
        acc[ai][bj][m][n] = __builtin_amdgcn_mfma_f32_16x16x32_bf16(Bt[n][k], At[m][k], acc[ai][bj][m][n], 0, 0, 0); __builtin_amdgcn_s_setprio(0); } while (0)
#define PG8_WAIT_V(n) asm volatile("s_waitcnt vmcnt(" #n ")" ::: "memory")
#define PG8_WAIT_L(n) asm volatile("s_waitcnt lgkmcnt(" #n ")" ::: "memory")
#define PG8_BAR __builtin_amdgcn_s_barrier()
#define PG8_SCHED __builtin_amdgcn_sched_barrier(0)
    Unit cur, nxt; int ui = 0;
    if (!S.next(0, cur)) return;
    f32x4 acc[2][2][4][2];
#pragma unroll
    for (int a = 0; a < 2; ++a)
#pragma unroll
        for (int b = 0; b < 2; ++b)
#pragma unroll
            for (int m = 0; m < 4; ++m)
#pragma unroll
                for (int n = 0; n < 2; ++n) acc[a][b][m][n] = (f32x4){0.f, 0.f, 0.f, 0.f};
    bf16x8 At[4][2], B0[2][2], B1[2][2];
    const char* cA = (const char*)g.A + (size_t)cur.pm * tstepA; const char* cB = (const char*)g.Bt + (size_t)cur.pn * tstepB;
    S.a_ready(cur);
    if constexpr (SP2) {
        PG8_STAGE(PG8_SB(0, 0), cB, voffB); PG8_STAGE(PG8_SB(0, 1), cB + hstepB, voffB); PG8_STAGE(PG8_SA(0, 0), cA, voffA); PG8_STAGE(PG8_SA(0, 1), cA + hstepA, voffA);
        if (wr == 1) PG8_BAR;
        PG8_WAIT_V(2); PG8_BAR;
        PG8_STAGE(PG8_SB(1, 0), cB + kstep, voffB); PG8_STAGE(PG8_SA(1, 0), cA + kstep, voffA); PG8_STAGE(PG8_SB(1, 1), cB + hstepB + kstep, voffB);
        PG8_WAIT_V(6); PG8_BAR;
    } else {
        PG8_STAGE(PG8_SB(0, 0), cB, voffB); PG8_STAGE(PG8_SA(0, 0), cA, voffA); PG8_STAGE(PG8_SB(0, 1), cB + hstepB, voffB); PG8_STAGE(PG8_SA(0, 1), cA + hstepA, voffA);
        if (wr == 1) PG8_BAR;
        PG8_WAIT_V(4); PG8_BAR;
        PG8_STAGE(PG8_SB(1, 0), cB + kstep, voffB); PG8_STAGE(PG8_SA(1, 0), cA + kstep, voffA); PG8_STAGE(PG8_SB(1, 1), cB + hstepB + kstep, voffB);
        PG8_WAIT_V(6); PG8_BAR;
    }
    for (;;) {
        const bool has_next = S.next(ui + 1, nxt);
        const char* nA = has_next ? (const char*)g.A + (size_t)nxt.pm * tstepA : cA; const char* nB = has_next ? (const char*)g.Bt + (size_t)nxt.pn * tstepB : cB;
        for (int t = 0; t < nt; t += 2) {
            const bool last = (t == nt - 2);
            const char* a1 = cA + (size_t)(t + 1) * kstep;
            const char* a2 = last ? nA : cA + (size_t)(t + 2) * kstep; const char* b2 = last ? nB : cB + (size_t)(t + 2) * kstep;
            const char* a3 = a2 + kstep; const char* b3 = b2 + kstep;
            if (last && has_next) S.a_ready(nxt);
            if constexpr (SP2) {
            PG8_LDB(B0, 0, 0); PG8_LDB(B1, 0, 1); PG8_SCHED; PG8_LDA(At, 0, 0); PG8_STAGE(PG8_SA(1, 1), a1 + hstepA, voffA);
            PG8_WAIT_V(8); PG8_WAIT_L(0); PG8_BAR; PG8_MMA(0, 0, At, B0); PG8_MMA(0, 1, At, B1); PG8_BAR; PG8_SCHED;
            PG8_LDA(At, 0, 1); PG8_STAGE(PG8_SB(0, 0), b2, voffB); PG8_STAGE(PG8_SB(0, 1), b2 + hstepB, voffB); PG8_STAGE(PG8_SA(0, 0), a2, voffA);
            PG8_WAIT_V(8); PG8_WAIT_L(0); PG8_BAR; PG8_MMA(1, 0, At, B0); PG8_MMA(1, 1, At, B1); PG8_BAR; PG8_SCHED;
            PG8_LDB(B0, 1, 0); PG8_LDB(B1, 1, 1); PG8_SCHED; PG8_LDA(At, 1, 0); PG8_STAGE(PG8_SA(0, 1), a2 + hstepA, voffA);
            PG8_WAIT_V(8); PG8_WAIT_L(0); PG8_BAR; PG8_MMA(0, 0, At, B0); PG8_MMA(0, 1, At, B1); PG8_BAR; PG8_SCHED;
            PG8_LDA(At, 1, 1); PG8_STAGE(PG8_SB(1, 0), b3, voffB); PG8_STAGE(PG8_SB(1, 1), b3 + hstepB, voffB); PG8_STAGE(PG8_SA(1, 0), a3, voffA);
            PG8_WAIT_V(8); PG8_WAIT_L(0); PG8_BAR; PG8_MMA(1, 0, At, B0); PG8_MMA(1, 1, At, B1); PG8_BAR; PG8_SCHED;
            } else {
            PG8_LDB(B0, 0, 0); PG8_SCHED; PG8_LDA(At, 0, 0); PG8_STAGE(PG8_SA(1, 1), a1 + hstepA, voffA);
            PG8_WAIT_L(8); PG8_BAR; PG8_WAIT_L(0); PG8_MMA(0, 0, At, B0); PG8_BAR; PG8_SCHED;
            PG8_LDB(B1, 0, 1); PG8_STAGE(PG8_SB(0, 0), b2, voffB);
            PG8_BAR; PG8_WAIT_L(0); PG8_MMA(0, 1, At, B1); PG8_BAR;
            PG8_LDA(At, 0, 1); PG8_STAGE(PG8_SA(0, 0), a2, voffA);
            PG8_BAR; PG8_WAIT_L(0); PG8_MMA(1, 0, At, B0); PG8_BAR; PG8_SCHED;
            PG8_STAGE(PG8_SB(0, 1), b2 + hstepB, voffB);
            PG8_WAIT_V(6); PG8_BAR; PG8_MMA(1, 1, At, B1); PG8_BAR;
            PG8_LDB(B0, 1, 0); PG8_SCHED; PG8_LDA(At, 1, 0); PG8_STAGE(PG8_SA(0, 1), a2 + hstepA, voffA);
            PG8_WAIT_L(8); PG8_BAR; PG8_WAIT_L(0); PG8_MMA(0, 0, At, B0); PG8_BAR; PG8_SCHED;
            PG8_LDB(B1, 1, 1); PG8_STAGE(PG8_SB(1, 0), b3, voffB);
            PG8_BAR; PG8_WAIT_L(0); PG8_MMA(0, 1, At, B1); PG8_BAR;
            PG8_LDA(At, 1, 1); PG8_STAGE(PG8_SA(1, 0), a3, voffA);
            PG8_BAR; PG8_WAIT_L(0); PG8_MMA(1, 0, At, B0); PG8_BAR; PG8_SCHED;
            PG8_STAGE(PG8_SB(1, 1), b3 + hstepB, voffB);
            PG8_WAIT_V(6); PG8_BAR; PG8_MMA(1, 1, At, B1); PG8_BAR;
            }
        }
        if constexpr (ALIGN_EPI) { if (wr == 0) PG8_BAR; }
        if constexpr (!Epi::AFTER_DRAIN) { E(acc, cur, wr, wc, fr, fq); S.done(cur); }
        if (!has_next) break;
#pragma unroll
        for (int a = 0; a < 2; ++a)
#pragma unroll
            for (int b = 0; b < 2; ++b)
#pragma unroll
                for (int m = 0; m < 4; ++m)
#pragma unroll
                    for (int n = 0; n < 2; ++n) acc[a][b][m][n] = (f32x4){0.f, 0.f, 0.f, 0.f};
        cur = nxt; cA = nA; cB = nB; ++ui;
        if constexpr (ALIGN_EPI) { if (wr == 1) PG8_BAR; }
    }
    PG8_WAIT_V(0);
    if constexpr (!ALIGN_EPI) { if (wr == 0) PG8_BAR; }
    PG8_BAR;
    if constexpr (Epi::AFTER_DRAIN) { E.fused(acc, cur, wr, wc, fr, fq, lds, wid, lane); S.done(cur); }
#undef PG8_SA
#undef PG8_SB
#undef PG8_STAGE
#undef PG8_LDA
#undef PG8_LDB
#undef PG8_MMA
#undef PG8_WAIT_V
#undef PG8_WAIT_L
#undef PG8_BAR
#undef PG8_SCHED
}
}
#ifndef PG8_SP2
#define PG8_SP2 true
#endif
#ifndef PG8_ALIGN
#define PG8_ALIGN true
#endif
constexpr int NWAVES = 8;
constexpr int BATCH = 8, SEQ = 4096, D = 1024, DEPTH = 4, M = BATCH * SEQ, DIN = 5632, NH = 8, HD = 64, DATT = 512, DCONV = 512, CW = 31;
constexpr float LN_EPS = 1e-5f;
constexpr float ALPHA = 1.6817928305074290861f;
constexpr int LDQ = 2048, LDG = 1536, LDS_G = 2048;
constexpr size_t MiB = 1u << 20;
constexpr size_t WS_CTL = 0;
constexpr size_t WS_WIN = 1 * MiB;
constexpr size_t WS_WBR = 45 * MiB;
constexpr size_t WS_WOUT = 53 * MiB;
constexpr size_t WS_XB = 64 * MiB;
constexpr size_t WS_QKVZ = 128 * MiB;
constexpr size_t WS_GLU = 256 * MiB;
constexpr size_t WS_SG = 352 * MiB;
constexpr size_t WS_VT = 480 * MiB;
constexpr size_t WS_END = 512 * MiB;
constexpr int LDS_BYTES = 147456;

#define GAS __attribute__((address_space(1)))
#define LAS __attribute__((address_space(3)))
typedef unsigned short bf16;
typedef unsigned v4u __attribute__((ext_vector_type(4)));
typedef unsigned v2u __attribute__((ext_vector_type(2)));
typedef float f32x4 __attribute__((ext_vector_type(4)));
typedef float f32x16 __attribute__((ext_vector_type(16)));
typedef short bf16x8 __attribute__((ext_vector_type(8)));
#define LDS_WAIT() asm volatile("s_waitcnt lgkmcnt(0)" ::: "memory")
__device__ __forceinline__ unsigned f2bf(float f) { unsigned u = __builtin_bit_cast(unsigned, f); return (u + 0x7fffu + ((u >> 16) & 1u)) >> 16; }
__device__ __forceinline__ unsigned pk2(float lo, float hi) { return f2bf(lo) | (f2bf(hi) << 16); }
__device__ __forceinline__ float bf_lo(unsigned w) { return __builtin_bit_cast(float, w << 16); }
__device__ __forceinline__ float bf_hi(unsigned w) { return __builtin_bit_cast(float, w & 0xffff0000u); }
__device__ __forceinline__ float bf2f(bf16 h) { return __builtin_bit_cast(float, ((unsigned)h) << 16); }
__device__ __forceinline__ float sigm(float v) { return __builtin_amdgcn_rcpf(1.0f + __expf(-v)); }
__device__ __forceinline__ float wave_sum(float v) {
#pragma unroll
    for (int o = 1; o < 64; o <<= 1) v += __shfl_xor(v, o);
    return v;
}

namespace pg8 {
struct EpiIn {
    static constexpr bool PERM = true, AFTER_DRAIN = false;
    bf16_t* QKVZ; bf16_t* GLU; bf16_t* SG; const float* bias; bf16_t* VT;
    __device__ __forceinline__ void operator()(const f32x4 (&acc)[2][2][4][2], const Unit& u, int wr, int wc, int fr, int fq) const {
        const int pn = u.pn; bf16_t* base; int ld, colt, act; float sc = 1.f;
        if (pn == 4 || pn == 5) {
            const int tok0 = u.pm * BM + wr * 64 + fr, bb = tok0 / SEQ, s0 = tok0 % SEQ, c0 = (pn - 4) * 256 + wc * 32 + 8 * fq, bcol0 = pn * BM + wc * 32 + 8 * fq;
            bf16_t* vb = VT + (size_t)bb * (NH * HD) * SEQ + s0;
#pragma unroll
            for (int bj = 0; bj < 2; ++bj)
#pragma unroll
                for (int n = 0; n < 2; ++n) { const f32x4 bvv = *(const f32x4*)(bias + bcol0 + bj * HALF + 4 * n);
#pragma unroll
                    for (int j = 0; j < 4; ++j) { bf16_t* cp = vb + (size_t)(c0 + bj * HALF + 4 * n + j) * SEQ;
#pragma unroll
                        for (int ai = 0; ai < 2; ++ai)
#pragma unroll
                            for (int m = 0; m < 4; ++m) cp[ai * HALF + m * 16] = (bf16_t)(cvt_pk_bf16(acc[ai][bj][m][n][j] + bvv[j], 0.f) & 0xffffu); } }
            return;
        }
        if (pn < 8) { base = QKVZ; ld = LDQ; colt = pn * 256; act = (pn >= 6) ? 1 : 0; if (pn < 2) sc = 0.125f; }
        else if (pn < 14) { base = GLU; ld = LDG; colt = (pn - 8) * 256; act = (pn < 10) ? 0 : ((pn < 12) ? 2 : 1); }
        else { base = SG; ld = LDS_G; colt = (pn - 14) * 256; act = 2; }
        const int row0 = u.pm * BM + wr * 64 + fr;
        const int col0 = colt + wc * 32 + 8 * fq, bcol0 = pn * BM + wc * 32 + 8 * fq;
        f32x4 bv[2][2];
#pragma unroll
        for (int bj = 0; bj < 2; ++bj)
#pragma unroll
            for (int n = 0; n < 2; ++n) bv[bj][n] = *(const f32x4*)(bias + bcol0 + bj * HALF + 4 * n);
#pragma unroll
        for (int ai = 0; ai < 2; ++ai)
#pragma unroll
            for (int m = 0; m < 4; ++m) { bf16_t* rowp = base + (size_t)(row0 + ai * HALF + m * 16) * ld + col0;
#pragma unroll
                for (int bj = 0; bj < 2; ++bj) { f32x4 v0 = acc[ai][bj][m][0] + bv[bj][0], v1 = acc[ai][bj][m][1] + bv[bj][1];
                    if (act == 1) {
#pragma unroll
                        for (int j = 0; j < 4; ++j) { v0[j] = v0[j] * sigm(v0[j]); v1[j] = v1[j] * sigm(v1[j]); } }
                    else if (act == 2) {
#pragma unroll
                        for (int j = 0; j < 4; ++j) { v0[j] = sigm(v0[j]); v1[j] = sigm(v1[j]); } }
                    v0 = v0 * sc; v1 = v1 * sc; u32x4 w; w.x = cvt_pk_bf16(v0[0], v0[1]); w.y = cvt_pk_bf16(v0[2], v0[3]); w.z = cvt_pk_bf16(v1[0], v1[1]); w.w = cvt_pk_bf16(v1[2], v1[3]);
                    *(u32x4*)(rowp + bj * HALF) = w; } }
    }
};
struct EpiBr1 {
    static constexpr bool PERM = true, AFTER_DRAIN = false;
    const bf16_t* SG; bf16_t* MG;
    __device__ __forceinline__ void operator()(const f32x4 (&acc)[2][2][4][2], const Unit& u, int wr, int wc, int fr, int fq) const {
        const int row0 = u.pm * BM + wr * 64 + fr, col0 = u.pn * BM + wc * 32 + 8 * fq;
#pragma unroll
        for (int ai = 0; ai < 2; ++ai)
#pragma unroll
            for (int m = 0; m < 4; ++m) { const size_t row = (size_t)(row0 + ai * HALF + m * 16);
#pragma unroll
                for (int bj = 0; bj < 2; ++bj) { const u32x4 g = *(const u32x4*)(SG + row * LDS_G + col0 + bj * HALF);
                    const f32x4 a0 = acc[ai][bj][m][0], a1 = acc[ai][bj][m][1]; u32x4 w;
                    w.x = cvt_pk_bf16(a0[0] * bf_lo(g.x), a0[1] * bf_hi(g.x)); w.y = cvt_pk_bf16(a0[2] * bf_lo(g.y), a0[3] * bf_hi(g.y));
                    w.z = cvt_pk_bf16(a1[0] * bf_lo(g.z), a1[1] * bf_hi(g.z)); w.w = cvt_pk_bf16(a1[2] * bf_lo(g.w), a1[3] * bf_hi(g.w));
                    *(u32x4*)(MG + row * D + col0 + bj * HALF) = w; } }
    }
};
struct EpiBr2 {
    static constexpr bool PERM = true, AFTER_DRAIN = false;
    const bf16_t* SG; bf16_t* MG; const float* bias;
    __device__ __forceinline__ void operator()(const f32x4 (&acc)[2][2][4][2], const Unit& u, int wr, int wc, int fr, int fq) const {
        const int row0 = u.pm * BM + wr * 64 + fr, col0 = u.pn * BM + wc * 32 + 8 * fq;
        f32x4 bv[2][2];
#pragma unroll
        for (int bj = 0; bj < 2; ++bj)
#pragma unroll
            for (int n = 0; n < 2; ++n) bv[bj][n] = *(const f32x4*)(bias + col0 + bj * HALF + 4 * n);
#pragma unroll
        for (int ai = 0; ai < 2; ++ai)
#pragma unroll
            for (int m = 0; m < 4; ++m) { const size_t row = (size_t)(row0 + ai * HALF + m * 16);
#pragma unroll
                for (int bj = 0; bj < 2; ++bj) { const u32x4 g = *(const u32x4*)(SG + row * LDS_G + D + col0 + bj * HALF);
                    bf16_t* mp = MG + row * D + col0 + bj * HALF; const u32x4 t = *(const u32x4*)mp;
                    const f32x4 a0 = acc[ai][bj][m][0] + bv[bj][0], a1 = acc[ai][bj][m][1] + bv[bj][1]; u32x4 w;
                    w.x = cvt_pk_bf16(bf_lo(t.x) + a0[0] * bf_lo(g.x), bf_hi(t.x) + a0[1] * bf_hi(g.x)); w.y = cvt_pk_bf16(bf_lo(t.y) + a0[2] * bf_lo(g.y), bf_hi(t.y) + a0[3] * bf_hi(g.y));
                    w.z = cvt_pk_bf16(bf_lo(t.z) + a1[0] * bf_lo(g.z), bf_hi(t.z) + a1[1] * bf_hi(g.z)); w.w = cvt_pk_bf16(bf_lo(t.w) + a1[2] * bf_lo(g.w), bf_hi(t.w) + a1[3] * bf_hi(g.w));
                    *(u32x4*)mp = w; } }
    }
};
struct EpiOut {
    static constexpr bool PERM = false, AFTER_DRAIN = false;
    const float* Xin; float* R;
    __device__ __forceinline__ void operator()(const f32x4 (&acc)[2][2][4][2], const Unit& u, int wr, int wc, int fr, int fq) const {
        const int row0 = u.pm * BM + wr * 64 + fr, col0 = u.pn * BM + wc * 32 + 4 * fq;
#pragma unroll
        for (int ai = 0; ai < 2; ++ai)
#pragma unroll
            for (int m = 0; m < 4; ++m) { const size_t off = (size_t)(row0 + ai * HALF + m * 16) * D + col0;
#pragma unroll
                for (int bj = 0; bj < 2; ++bj)
#pragma unroll
                    for (int n = 0; n < 2; ++n) { const f32x4 x = *(const f32x4*)(Xin + off + bj * HALF + n * 16); *(f32x4*)(R + off + bj * HALF + n * 16) = x * ALPHA + acc[ai][bj][m][n]; } }
    }
};
}

__device__ __forceinline__ void p0_transpose_item(const float* W, int N, bf16* WT, int ldt, int koff, LAS float* scr, int item, int lane) {
    const int nblk = N / 32, kb = item / nblk, nb = item % nblk, k0 = 64 * kb, n0 = 32 * nb;
#pragma unroll 8
    for (int i = 0; i < 32; ++i) { const int kk = 2 * i + (lane >> 5); scr[kk * 33 + (lane & 31)] = W[(size_t)(k0 + kk) * N + n0 + (lane & 31)]; }
    LDS_WAIT(); asm volatile("" ::: "memory");
    const int c = lane & 7;
#pragma unroll
    for (int j = 0; j < 4; ++j) { const int n = (lane >> 3) + 8 * j; const LAS float* s = scr + (8 * c) * 33 + n;
        v4u o; o.x = pk2(s[0 * 33], s[1 * 33]); o.y = pk2(s[2 * 33], s[3 * 33]); o.z = pk2(s[4 * 33], s[5 * 33]); o.w = pk2(s[6 * 33], s[7 * 33]);
        *(v4u*)(WT + (size_t)(n0 + n) * ldt + koff + k0 + 8 * c) = o; }
    LDS_WAIT(); asm volatile("" ::: "memory");
}

__device__ __forceinline__ void attn_item(const bf16* QKVZ, const bf16* VT, bf16* BRA, int b, int h, int qt, int lane) {
    const int r = lane & 31, hh = lane >> 5, q0 = qt * 32;
    const bf16* qp = QKVZ + (size_t)(b * SEQ + q0 + r) * LDQ + h * HD + hh * 8;
    bf16x8 qf[4];
#pragma unroll
    for (int kk = 0; kk < 4; ++kk) qf[kk] = *(const bf16x8*)(qp + kk * 16);
    f32x16 o0, o1;
#pragma unroll
    for (int i = 0; i < 16; ++i) { o0[i] = 0.f; o1[i] = 0.f; }
    float carry = 0.f;
    for (int kb = qt; kb >= 0; --kb) {
        const int k0 = kb * 32;
        const bf16* kp = QKVZ + (size_t)(b * SEQ + k0 + r) * LDQ + DATT + h * HD + hh * 8;
        bf16x8 kf[4];
#pragma unroll
        for (int kk = 0; kk < 4; ++kk) kf[kk] = *(const bf16x8*)(kp + kk * 16);
        const bf16* vp = VT + ((size_t)((b * NH + h) * HD + r)) * SEQ + k0 + 4 * hh;
        bf16x8 vf[2][2];
#pragma unroll
        for (int dblk = 0; dblk < 2; ++dblk)
#pragma unroll
            for (int s = 0; s < 2; ++s) {
                const v2u lo = *(const v2u*)(vp + (size_t)dblk * 32 * SEQ + 16 * s), hi = *(const v2u*)(vp + (size_t)dblk * 32 * SEQ + 16 * s + 8);
                v4u t; t.x = lo.x; t.y = lo.y; t.z = hi.x; t.w = hi.y; vf[dblk][s] = __builtin_bit_cast(bf16x8, t);
            }
        f32x16 z;
#pragma unroll
        for (int i = 0; i < 16; ++i) z[i] = 0.f;
#pragma unroll
        for (int kk = 0; kk < 4; ++kk) z = __builtin_amdgcn_mfma_f32_32x32x16_bf16(kf[kk], qf[kk], z, 0, 0, 0);
        if (kb == qt) {
#pragma unroll
            for (int i = 0; i < 16; ++i) { const int krow = (i & 3) + 8 * (i >> 2) + 4 * hh; z[i] = (krow < r) ? z[i] : -1e30f; }
        }
        float lf[16], G[4];
#pragma unroll
        for (int i = 0; i < 16; ++i) {
            const float zz = z[i];
            lf[i] = -(fmaxf(zz, 0.f) + __logf(1.0f + __expf(-fabsf(zz))));
        }
#pragma unroll
        for (int g = 0; g < 4; ++g) G[g] = (lf[4 * g] + lf[4 * g + 1]) + (lf[4 * g + 2] + lf[4 * g + 3]);
        float Gp[4];
#pragma unroll
        for (int g = 0; g < 4; ++g) Gp[g] = __shfl_xor(G[g], 32);
        float w[16];
        float suf = carry;
#pragma unroll
        for (int g = 3; g >= 0; --g) {
            float later = suf + (hh == 0 ? Gp[g] : 0.f);
#pragma unroll
            for (int ii = 3; ii >= 0; --ii) {
                const int i = 4 * g + ii;
                w[i] = __expf(z[i] + lf[i] + later);
                later += lf[i];
            }
            suf += G[g] + Gp[g];
        }
        carry = suf;
        bf16x8 pb[2];
#pragma unroll
        for (int s = 0; s < 2; ++s) {
            v4u t; t.x = pk2(w[8 * s + 0], w[8 * s + 1]); t.y = pk2(w[8 * s + 2], w[8 * s + 3]); t.z = pk2(w[8 * s + 4], w[8 * s + 5]); t.w = pk2(w[8 * s + 6], w[8 * s + 7]);
            pb[s] = __builtin_bit_cast(bf16x8, t);
        }
#pragma unroll
        for (int s = 0; s < 2; ++s) {
            o0 = __builtin_amdgcn_mfma_f32_32x32x16_bf16(vf[0][s], pb[s], o0, 0, 0, 0);
            o1 = __builtin_amdgcn_mfma_f32_32x32x16_bf16(vf[1][s], pb[s], o1, 0, 0, 0);
        }
        if (__all(carry < -90.f)) break;
    }
    const size_t row = (size_t)(b * SEQ + q0 + r);
    const bf16* zp = QKVZ + row * LDQ + 3 * DATT + h * HD + 4 * hh;
    bf16* op = BRA + row * D + h * HD + 4 * hh;
#pragma unroll
    for (int dblk = 0; dblk < 2; ++dblk)
#pragma unroll
        for (int g = 0; g < 4; ++g) {
            const int d0 = dblk * 32 + 8 * g;
            const v2u zz = *(const v2u*)(zp + d0);
            const f32x16& o = dblk ? o1 : o0;
            v2u t; t.x = pk2(o[4 * g + 0] * bf_lo(zz.x), o[4 * g + 1] * bf_hi(zz.x)); t.y = pk2(o[4 * g + 2] * bf_lo(zz.y), o[4 * g + 3] * bf_hi(zz.y));
            *(v2u*)(op + d0) = t;
        }
}

__device__ __forceinline__ void conv_item(const bf16* GLU, bf16* BRA, const float* cw, const float* cb, const float* lng, const float* lnb,
                                          int b, int tt, LAS float* cbuf, int tid) {
    const int c = tid, t0 = tt * 32;
    float wv[CW];
#pragma unroll
    for (int j = 0; j < CW; ++j) wv[j] = cw[j * DCONV + c];
    const float bias = cb[c];
    float c0[62];
    const bf16* gp = GLU + (size_t)(b * SEQ) * LDG + c;
#pragma unroll
    for (int i = 0; i < 62; ++i) {
        const int t = t0 - 30 + i;
        float v = 0.f;
        if (t >= 0) { const bf16* p = gp + (size_t)t * LDG; v = bf2f(p[0]) * bf2f(p[DCONV]); }
        c0[i] = v;
    }
#pragma unroll
    for (int t = 0; t < 32; ++t) {
        float a = bias;
#pragma unroll
        for (int j = 0; j < CW; ++j) a = fmaf(wv[j], c0[t + j], a);
        cbuf[t * DCONV + c] = a;
    }
    __syncthreads();
    const int wave = tid >> 6, lane = tid & 63;
    const f32x4 g0 = *(const f32x4*)(lng + 4 * lane), g1 = *(const f32x4*)(lng + 256 + 4 * lane);
    const f32x4 b0 = *(const f32x4*)(lnb + 4 * lane), b1 = *(const f32x4*)(lnb + 256 + 4 * lane);
#pragma unroll
    for (int q = 0; q < 4; ++q) {
        const int t = wave * 4 + q;
        f32x4 v0 = *(const LAS f32x4*)(cbuf + t * DCONV + 4 * lane), v1 = *(const LAS f32x4*)(cbuf + t * DCONV + 256 + 4 * lane);
        const float mean = wave_sum((v0[0] + v0[1]) + (v0[2] + v0[3]) + (v1[0] + v1[1]) + (v1[2] + v1[3])) * (1.f / DCONV);
        v0 = v0 - mean; v1 = v1 - mean;
        const float var = wave_sum((v0[0] * v0[0] + v0[1] * v0[1]) + (v0[2] * v0[2] + v0[3] * v0[3]) + (v1[0] * v1[0] + v1[1] * v1[1]) + (v1[2] * v1[2] + v1[3] * v1[3])) * (1.f / DCONV);
        const float rstd = 1.0f / sqrtf(var + LN_EPS);
        const size_t row = (size_t)(b * SEQ + t0 + t);
        const bf16* zp = GLU + row * LDG + 2 * DCONV;
        const v2u z0 = *(const v2u*)(zp + 4 * lane), z1 = *(const v2u*)(zp + 256 + 4 * lane);
        f32x4 y0 = v0 * rstd * g0 + b0, y1 = v1 * rstd * g1 + b1;
#pragma unroll
        for (int j = 0; j < 4; ++j) { y0[j] = y0[j] * sigm(y0[j]); y1[j] = y1[j] * sigm(y1[j]); }
        v2u w0, w1;
        w0.x = pk2(y0[0] * bf_lo(z0.x), y0[1] * bf_hi(z0.x)); w0.y = pk2(y0[2] * bf_lo(z0.y), y0[3] * bf_hi(z0.y));
        w1.x = pk2(y1[0] * bf_lo(z1.x), y1[1] * bf_hi(z1.x)); w1.y = pk2(y1[2] * bf_lo(z1.y), y1[3] * bf_hi(z1.y));
        bf16* op = BRA + row * D + DATT;
        *(v2u*)(op + 4 * lane) = w0; *(v2u*)(op + 256 + 4 * lane) = w1;
    }
    __syncthreads();
}

__device__ __forceinline__ void ln_row(float* xrow, bf16* orow, const float* g, const float* bta, int lane) {
    f32x4* xr = (f32x4*)xrow + lane;
    f32x4 v[4]; float s = 0.f;
#pragma unroll
    for (int j = 0; j < 4; ++j) { v[j] = xr[64 * j]; s += (v[j].x + v[j].y) + (v[j].z + v[j].w); }
    const float mean = wave_sum(s) * (1.f / D); float s2 = 0.f;
#pragma unroll
    for (int j = 0; j < 4; ++j) { v[j] = v[j] - mean; s2 += (v[j].x * v[j].x + v[j].y * v[j].y) + (v[j].z * v[j].z + v[j].w * v[j].w); }
    const float rstd = 1.f / sqrtf(wave_sum(s2) * (1.f / D) + LN_EPS);
    unsigned long long* o8 = (unsigned long long*)orow + lane;
#pragma unroll
    for (int j = 0; j < 4; ++j) {
        const f32x4 gg = *((const f32x4*)g + lane + 64 * j), bb = *((const f32x4*)bta + lane + 64 * j);
        const f32x4 y = v[j] * rstd * gg + bb;
        xr[64 * j] = y;
        o8[64 * j] = (unsigned long long)pk2(y.x, y.y) | ((unsigned long long)pk2(y.z, y.w) << 32);
    }
}

struct Args { const float* in[13]; float* out; unsigned char* ws; };
#define CAS __attribute__((address_space(4)))
typedef const CAS unsigned long long* kargp_t;
__device__ __forceinline__ kargp_t kargs_fresh() { kargp_t p = (kargp_t)__builtin_amdgcn_kernarg_segment_ptr(); asm volatile("" : "+s"(p)); return p; }
#define KIN(ka, i) ((const float*)(ka)[i])
#define KOUT(ka) ((float*)(ka)[13])
#define KWS(ka) ((unsigned char*)(ka)[14])
__global__ void __launch_bounds__(NWAVES * 64, 2) hybrid_fwd(Args args_unused) {
    extern __shared__ __attribute__((aligned(16))) unsigned char lds_raw[];
    LAS unsigned char* lds = (LAS unsigned char*)lds_raw;
    cg::grid_group grid = cg::this_grid();
#define PHASE_IDS() int tid_l = threadIdx.x; asm volatile("" : "+v"(tid_l)); const int tid = tid_l, lane = tid & 63, wave = __builtin_amdgcn_readfirstlane(tid >> 6)
#define GRID_G ((int)gridDim.x)
#define BX ((int)blockIdx.x)
#define VCU ((GRID_G % 8 == 0) ? (BX % 8) * (GRID_G / 8) + BX / 8 : BX)
#define GW (VCU * NWAVES + wave)
#define NGW (GRID_G * NWAVES)

    {
        PHASE_IDS();
        kargp_t ka = kargs_fresh(); unsigned char* ws = KWS(ka);
        bf16* WIN = (bf16*)(ws + WS_WIN); bf16* WBR = (bf16*)(ws + WS_WBR); bf16* WOUT = (bf16*)(ws + WS_WOUT); bf16* XB = (bf16*)(ws + WS_XB);
        const float* x_in = KIN(ka, 0); const float* w_in = KIN(ka, 1); const float* w_att = KIN(ka, 7); const float* w_conv = KIN(ka, 8); const float* w_out = KIN(ka, 10);
        LAS float* scr = (LAS float*)(lds + wave * 16384);
        constexpr int I_IN = (D / 64) * (DIN / 32), I_BR = (DATT / 64) * (D / 32), I_OUT = (D / 64) * (D / 32), I_L = I_IN + 2 * I_BR + I_OUT;
        for (int it = GW; it < DEPTH * I_L; it += NGW) {
            const int l = it / I_L; int r = it % I_L;
            if (r < I_IN) { p0_transpose_item(w_in + (size_t)l * D * DIN, DIN, WIN + (size_t)l * DIN * D, D, 0, scr, r, lane); continue; } r -= I_IN;
            if (r < I_BR) { p0_transpose_item(w_att + (size_t)l * DATT * D, D, WBR + (size_t)l * D * 1024, 1024, 0, scr, r, lane); continue; } r -= I_BR;
            if (r < I_BR) { p0_transpose_item(w_conv + (size_t)l * DCONV * D, D, WBR + (size_t)l * D * 1024, 1024, DATT, scr, r, lane); continue; } r -= I_BR;
            p0_transpose_item(w_out + (size_t)l * D * D, D, WOUT + (size_t)l * D * D, D, 0, scr, r, lane);
        }
        const size_t nchunk = (size_t)M * D / 8;
        for (size_t i = (size_t)BX * (NWAVES * 64) + tid; i < nchunk; i += (size_t)GRID_G * NWAVES * 64) {
            const f32x4 a = *((const f32x4*)x_in + 2 * i), bq = *((const f32x4*)x_in + 2 * i + 1);
            v4u o; o.x = pk2(a.x, a.y); o.y = pk2(a.z, a.w); o.z = pk2(bq.x, bq.y); o.w = pk2(bq.z, bq.w);
            *((v4u*)XB + i) = o;
        }
    }
    grid.sync();

    for (int l = 0; l < DEPTH; ++l) {
        {
            kargp_t ka = kargs_fresh(); unsigned char* ws = KWS(ka);
            pg8::Gemm g{(bf16*)(ws + WS_XB), (bf16*)(ws + WS_WIN) + (size_t)l * DIN * D, M, DIN, D, D, D}; pg8::StaticOrder S; S.init(M, DIN, GRID_G, BX);
            pg8::EpiIn E{(bf16*)(ws + WS_QKVZ), (bf16*)(ws + WS_GLU), (bf16*)(ws + WS_SG), KIN(ka, 2) + (size_t)l * DIN, (bf16*)(ws + WS_VT)};
            pg8::gemm_phase<pg8::EpiIn, pg8::StaticOrder, PG8_ALIGN, PG8_SP2>(lds, g, S, E);
        }
        grid.sync();
        {
            PHASE_IDS();
            kargp_t ka = kargs_fresh(); unsigned char* ws = KWS(ka);
            const bf16* QKVZ = (const bf16*)(ws + WS_QKVZ); const bf16* VT = (const bf16*)(ws + WS_VT); bf16* BRA = (bf16*)(ws + WS_XB); const bf16* GLU = (const bf16*)(ws + WS_GLU);
            for (int it = GW; it < BATCH * NH * (SEQ / 32); it += NGW) {
                const int qt = (SEQ / 32 - 1) - it / (BATCH * NH), bh = it % (BATCH * NH);
                attn_item(QKVZ, VT, BRA, bh / NH, bh % NH, qt, lane);
            }
            LAS float* cbuf = (LAS float*)lds;
            const float* conv_w = KIN(ka, 3) + (size_t)l * CW * DCONV; const float* conv_b = KIN(ka, 4) + (size_t)l * DCONV;
            const float* cln_g = KIN(ka, 5) + (size_t)l * DCONV; const float* cln_b = KIN(ka, 6) + (size_t)l * DCONV;
            for (int it = BX; it < BATCH * (SEQ / 32); it += GRID_G)
                conv_item(GLU, BRA, conv_w, conv_b, cln_g, cln_b, it / (SEQ / 32), it % (SEQ / 32), cbuf, tid);
        }
        grid.sync();
        {
            kargp_t ka = kargs_fresh(); unsigned char* ws = KWS(ka);
            const bf16* wbr = (const bf16*)(ws + WS_WBR) + (size_t)l * D * 1024; const bf16* BRA = (const bf16*)(ws + WS_XB);
            pg8::StaticOrder S; S.init(M, D, GRID_G, BX);
            pg8::Gemm g{BRA, wbr, M, D, DATT, 1024, 1024}; pg8::EpiBr1 E{(const bf16*)(ws + WS_SG), (bf16*)(ws + WS_QKVZ)};
            pg8::gemm_phase<pg8::EpiBr1, pg8::StaticOrder, PG8_ALIGN, PG8_SP2>(lds, g, S, E);
        }
        {
            kargp_t ka = kargs_fresh(); unsigned char* ws = KWS(ka);
            const bf16* wbr = (const bf16*)(ws + WS_WBR) + (size_t)l * D * 1024; const bf16* BRA = (const bf16*)(ws + WS_XB);
            pg8::StaticOrder S; S.init(M, D, GRID_G, BX);
            pg8::Gemm g{BRA + DATT, wbr + DATT, M, D, DCONV, 1024, 1024}; pg8::EpiBr2 E{(const bf16*)(ws + WS_SG), (bf16*)(ws + WS_QKVZ), KIN(ka, 9) + (size_t)l * D};
            pg8::gemm_phase<pg8::EpiBr2, pg8::StaticOrder, PG8_ALIGN, PG8_SP2>(lds, g, S, E);
        }
        grid.sync();
        {
            kargp_t ka = kargs_fresh(); unsigned char* ws = KWS(ka);
            pg8::Gemm g{(const bf16*)(ws + WS_QKVZ), (const bf16*)(ws + WS_WOUT) + (size_t)l * D * D, M, D, D, D, D}; pg8::StaticOrder S; S.init(M, D, GRID_G, BX);
            pg8::EpiOut E{l == 0 ? KIN(ka, 0) : (const float*)KOUT(ka), KOUT(ka)};
            pg8::gemm_phase<pg8::EpiOut, pg8::StaticOrder, PG8_ALIGN, PG8_SP2>(lds, g, S, E);
        }
        grid.sync();
        {
            PHASE_IDS();
            kargp_t ka = kargs_fresh(); unsigned char* ws = KWS(ka);
            float* out = KOUT(ka); bf16* XB = (bf16*)(ws + WS_XB); const float* ln_g = KIN(ka, 11) + (size_t)l * D; const float* ln_b = KIN(ka, 12) + (size_t)l * D;
            for (int m = GW; m < M; m += NGW) ln_row(out + (size_t)m * D, XB + (size_t)m * D, ln_g, ln_b, lane);
        }
        if (l + 1 < DEPTH) grid.sync();
    }
}

extern "C" void kernel_launch(void* const* d_in, const int* in_sizes, int n_in, void* d_out, int out_size, void* d_ws, size_t ws_size, hipStream_t stream) {
    static int grid = 0;
    if (grid == 0) {
        if (n_in != 13 || in_sizes[0] != M * D || out_size != M * D || ws_size < WS_END) { fprintf(stderr, "kernel_launch: unexpected shapes / workspace (n_in %d, in0 %d, out %d, ws %zu); nothing launched\n", n_in, n_in > 0 ? in_sizes[0] : -1, out_size, ws_size); grid = -1; return; }
        int dev = 0, cus = 0, per_cu = 0;
        if (hipGetDevice(&dev) != hipSuccess || hipDeviceGetAttribute(&cus, hipDeviceAttributeMultiprocessorCount, dev) != hipSuccess) { grid = -1; return; }
        if (hipFuncSetAttribute((const void*)hybrid_fwd, hipFuncAttributeMaxDynamicSharedMemorySize, LDS_BYTES) != hipSuccess) { fprintf(stderr, "kernel_launch: hipFuncSetAttribute failed\n"); grid = -1; return; }
        if (hipOccupancyMaxActiveBlocksPerMultiprocessor(&per_cu, (const void*)hybrid_fwd, NWAVES * 64, LDS_BYTES) != hipSuccess || per_cu < 1) { fprintf(stderr, "kernel_launch: occupancy query says %d\n", per_cu); }
        (void)hipGetLastError();
        grid = cus;
    }
    if (grid < 0) return;
    Args a{};
    for (int i = 0; i < 13; ++i) a.in[i] = (const float*)d_in[i];
    a.out = (float*)d_out; a.ws = (unsigned char*)d_ws;
    void* kargs[] = {&a};
    hipError_t e = hipLaunchCooperativeKernel((const void*)hybrid_fwd, dim3(grid), dim3(NWAVES * 64), kargs, LDS_BYTES, stream);
    if (e != hipSuccess) fprintf(stderr, "kernel_launch: cooperative launch failed: %s (grid %d)\n", hipGetErrorString(e), grid);
}
```
